# Optimizing an MI355X kernel written in HIP

```python
import math
import jax, jax.numpy as jnp
from jax import lax
import numpy as np

D_MODEL = 1024
BATCH = 2
SEQ = 8192
DEPTH = 1

RET_HEADS = 4
RET_HEAD_DIM = 128
RET_WIDTH = RET_HEADS * RET_HEAD_DIM
RET_CHUNK = 128
SWA_Q_HEADS = 8
SWA_KV_HEADS = 2
SWA_HEAD_DIM = 64
SWA_WIDTH = SWA_Q_HEADS * SWA_HEAD_DIM
SWA_KV_WIDTH = SWA_KV_HEADS * SWA_HEAD_DIM
WINDOW = 128
MIX_WIDTH = RET_WIDTH + SWA_WIDTH
IN_COLS = 4 * RET_WIDTH + SWA_WIDTH + 2 * SWA_KV_WIDTH
ROPE_THETA = 10000.0
PEER_HEADS = 8
PEER_N_KEYS = 128
PEER_N_EXPERTS = PEER_N_KEYS * PEER_N_KEYS
PEER_QUERY_DIM = 256
PEER_HALF = PEER_QUERY_DIM // 2
PEER_TOPK = 16
PEER_TOKEN_BLOCK = 128
LN_EPS = 1e-5
GN_EPS = 1e-6
ALPHA = (2.0 * DEPTH) ** 0.25
BETA = (8.0 * DEPTH) ** -0.25
NEG_INF = -1e30

kernel_name = "hymba_retnet_swa_peer_deepnorm"


def layer_norm(x, w, b):
    xf = x.astype(jnp.float32)
    mu = jnp.mean(xf, axis=-1, keepdims=True)
    var = jnp.mean(jnp.square(xf - mu), axis=-1, keepdims=True)
    return ((xf - mu) * lax.rsqrt(var + LN_EPS) * w.astype(jnp.float32) + b.astype(jnp.float32)).astype(x.dtype)


def head_group_norm(y):
    yf = y.astype(jnp.float32)
    mu = jnp.mean(yf, axis=-1, keepdims=True)
    var = jnp.mean(jnp.square(yf - mu), axis=-1, keepdims=True)
    return ((yf - mu) * lax.rsqrt(var + GN_EPS)).astype(y.dtype)


def rotary(x, pos):
    d = x.shape[-1]
    inv = 1.0 / (ROPE_THETA ** (jnp.arange(0, d, 2, dtype=jnp.float32) / d))
    ang = pos.astype(jnp.float32)[:, None] * inv[None, :]
    cos = jnp.cos(ang)[None, :, None, :]
    sin = jnp.sin(ang)[None, :, None, :]
    xf = x.astype(jnp.float32)
    x1, x2 = xf[..., : d // 2], xf[..., d // 2:]
    out = jnp.concatenate([x1 * cos - x2 * sin, x2 * cos + x1 * sin], axis=-1)
    return out.astype(x.dtype)


def retention(q, k, v):
    B, S, H, d = q.shape
    C = RET_CHUNK
    n = S // C
    dt = q.dtype
    log_g = jnp.log(1.0 - 2.0 ** (-5.0 - jnp.arange(H, dtype=jnp.float32)))
    k = k * (d ** -0.5)
    qc = q.reshape(B, n, C, H, d).transpose(0, 3, 1, 2, 4)
    kc = k.reshape(B, n, C, H, d).transpose(0, 3, 1, 2, 4)
    vc = v.reshape(B, n, C, H, d).transpose(0, 3, 1, 2, 4)
    idx = jnp.arange(C, dtype=jnp.float32)
    diff = idx[:, None] - idx[None, :]
    decay = jnp.where(diff[None] >= 0,
                      jnp.exp(jnp.maximum(diff, 0.0)[None] * log_g[:, None, None]), 0.0).astype(dt)
    zeta = jnp.exp((C - 1.0 - idx)[None] * log_g[:, None]).astype(dt)
    xi = jnp.exp((idx + 1.0)[None] * log_g[:, None]).astype(dt)
    g_chunk = jnp.exp(C * log_g)
    scores = jnp.einsum('bhncd,bhnmd->bhncm', qc, kc) * decay[None, :, None]
    y_intra = jnp.einsum('bhncm,bhnme->bhnce', scores, vc)
    chunk_kv = jnp.einsum('bhnmd,bhnme->bhnde', kc * zeta[None, :, None, :, None], vc)
    kv_seq = jnp.moveaxis(chunk_kv, 2, 0)
    gc = g_chunk.astype(kv_seq.dtype)[None, :, None, None]

    def step(state, kv):
        return state * gc + kv, state

    _, prev = lax.scan(step, jnp.zeros_like(kv_seq[0]), kv_seq)
    prev = jnp.moveaxis(prev, 0, 2)
    y_cross = jnp.einsum('bhncd,bhnde->bhnce', qc * xi[None, :, None, :, None], prev)
    y = (y_intra + y_cross).transpose(0, 2, 3, 1, 4).reshape(B, S, H, d)
    return y


def sliding_window_attention(q, k, v, sinks):
    B, S, Hq, d = q.shape
    Hkv = k.shape[2]
    G = Hq // Hkv
    W = WINDOW
    n = S // W
    qb = q.reshape(B, n, W, Hkv, G, d)
    kb = k.reshape(B, n, W, Hkv, d)
    vb = v.reshape(B, n, W, Hkv, d)
    zk = jnp.zeros_like(kb[:, :1])
    kk = jnp.concatenate([jnp.concatenate([zk, kb[:, :-1]], axis=1), kb], axis=2)
    vv = jnp.concatenate([jnp.concatenate([zk, vb[:, :-1]], axis=1), vb], axis=2)
    s = jnp.einsum('bnqhgd,bnkhd->bnhgqk', qb, kk).astype(jnp.float32) * (d ** -0.5)
    qi = jnp.arange(W)[:, None] + W
    kj = jnp.arange(2 * W)[None, :]
    rel = qi - kj
    blk = jnp.arange(n)
    valid = ((rel >= 0) & (rel < W))[None] & ((blk[:, None, None] > 0) | (kj[None] >= W))
    s = jnp.where(valid[None, :, None, None], s, NEG_INF)
    sink = jnp.broadcast_to(sinks.astype(jnp.float32).reshape(Hkv, G)[None, None, :, :, None, None],
                            s.shape[:-1] + (1,))
    p = jax.nn.softmax(jnp.concatenate([s, sink], axis=-1), axis=-1)[..., :-1]
    o = jnp.einsum('bnhgqk,bnkhd->bnqhgd', p.astype(v.dtype), vv)
    return o.reshape(B, S, Hq, d)


def peer_ffn(x, w_pq, sub_keys, u_tab, v_tab):
    B, S, D = x.shape
    T = B * S
    H, K = PEER_HEADS, PEER_TOPK
    xt = x.reshape(T, D)
    q = (xt @ w_pq).reshape(T, H, 2, PEER_HALF)
    s = jnp.einsum('thpd,hpkd->thpk', q, sub_keys)
    s1, i1 = lax.top_k(s[:, :, 0], K)
    s2, i2 = lax.top_k(s[:, :, 1], K)
    cand = (s1[..., :, None] + s2[..., None, :]).reshape(T, H, K * K)
    cand_idx = (i1[..., :, None] * PEER_N_KEYS + i2[..., None, :]).reshape(T, H, K * K)
    top_s, pos = lax.top_k(cand, K)
    idx = jnp.take_along_axis(cand_idx, pos, axis=-1)
    g = jax.nn.softmax(top_s.astype(jnp.float32), axis=-1).astype(x.dtype)
    c = PEER_TOKEN_BLOCK
    nb = T // c

    def block(args):
        xb, ib, gb = args
        ib = ib.reshape(c, H * K)
        gb = gb.reshape(c, H * K)
        u = jnp.take(u_tab, ib, axis=0)
        a = jax.nn.gelu(jnp.einsum('cd,ced->ce', xb, u), approximate=False) * gb
        vsel = jnp.take(v_tab, ib, axis=0)
        return jnp.einsum('ce,ced->cd', a, vsel)

    y = lax.map(block, (xt.reshape(nb, c, D), idx.reshape(nb, c, H, K), g.reshape(nb, c, H, K)))
    return y.reshape(B, S, D)


def setup_inputs(seed: int = 0) -> dict:
    key = jax.random.key(seed)
    ks = jax.random.split(key, 13)
    f32 = jnp.float32
    col_scale = jnp.concatenate([
        jnp.ones((2 * RET_WIDTH,), f32),
        jnp.full((RET_WIDTH,), BETA, f32),
        jnp.ones((RET_WIDTH,), f32),
        jnp.ones((SWA_WIDTH + SWA_KV_WIDTH,), f32),
        jnp.full((SWA_KV_WIDTH,), BETA, f32),
    ])
    x = jax.random.normal(ks[0], (BATCH, SEQ, D_MODEL), f32)
    w_in = jax.random.normal(ks[1], (DEPTH, D_MODEL, IN_COLS), f32) * (D_MODEL ** -0.5) * col_scale
    ret_gn_w = 1.0 + 0.02 * jax.random.normal(ks[2], (DEPTH, RET_WIDTH), f32)
    swa_sinks = 0.5 * jax.random.normal(ks[3], (DEPTH, SWA_Q_HEADS), f32)
    w_out = jax.random.normal(ks[4], (DEPTH, MIX_WIDTH, D_MODEL), f32) * (MIX_WIDTH ** -0.5) * BETA
    ln1_w = 1.0 + 0.02 * jax.random.normal(ks[5], (DEPTH, D_MODEL), f32)
    ln1_b = 0.02 * jax.random.normal(ks[6], (DEPTH, D_MODEL), f32)
    w_pq = jax.random.normal(ks[7], (DEPTH, D_MODEL, PEER_HEADS * PEER_QUERY_DIM), f32) * (D_MODEL ** -0.5)
    peer_sub_keys = jax.random.normal(ks[8], (DEPTH, PEER_HEADS, 2, PEER_N_KEYS, PEER_HALF), f32) * (PEER_HALF ** -0.5)
    peer_u = jax.random.normal(ks[9], (DEPTH, PEER_N_EXPERTS, D_MODEL), f32) * (D_MODEL ** -0.5) * BETA
    peer_v = jax.random.normal(ks[10], (DEPTH, PEER_N_EXPERTS, D_MODEL), f32) * BETA
    ln2_w = 1.0 + 0.02 * jax.random.normal(ks[11], (DEPTH, D_MODEL), f32)
    ln2_b = 0.02 * jax.random.normal(ks[12], (DEPTH, D_MODEL), f32)
    return {"x": x, "w_in": w_in, "ret_gn_w": ret_gn_w, "swa_sinks": swa_sinks, "w_out": w_out,
            "ln1_w": ln1_w, "ln1_b": ln1_b, "w_pq": w_pq, "peer_sub_keys": peer_sub_keys,
            "peer_u": peer_u, "peer_v": peer_v, "ln2_w": ln2_w, "ln2_b": ln2_b}


def reference(x, w_in, ret_gn_w, swa_sinks, w_out, ln1_w, ln1_b, w_pq, peer_sub_keys,
              peer_u, peer_v, ln2_w, ln2_b):
    B, S, D = x.shape
    pos = jnp.arange(S)
    o1 = RET_WIDTH
    splits = [o1, 2 * o1, 3 * o1, 4 * o1, 4 * o1 + SWA_WIDTH, 4 * o1 + SWA_WIDTH + SWA_KV_WIDTH]
    h = x
    for l in range(DEPTH):
        proj = h @ w_in[l]
        rq, rk, rv, rg, sq, sk, sv = jnp.split(proj, splits, axis=-1)
        rq = rotary(rq.reshape(B, S, RET_HEADS, RET_HEAD_DIM), pos)
        rk = rotary(rk.reshape(B, S, RET_HEADS, RET_HEAD_DIM), pos)
        rv = rv.reshape(B, S, RET_HEADS, RET_HEAD_DIM)
        y_ret = head_group_norm(retention(rq, rk, rv)).reshape(B, S, RET_WIDTH) * ret_gn_w[l]
        y_ret = jax.nn.silu(rg) * y_ret
        sq = rotary(sq.reshape(B, S, SWA_Q_HEADS, SWA_HEAD_DIM), pos)
        sk = rotary(sk.reshape(B, S, SWA_KV_HEADS, SWA_HEAD_DIM), pos)
        sv = sv.reshape(B, S, SWA_KV_HEADS, SWA_HEAD_DIM)
        y_swa = sliding_window_attention(sq, sk, sv, swa_sinks[l]).reshape(B, S, SWA_WIDTH)
        mix = jnp.concatenate([y_ret, y_swa], axis=-1) @ w_out[l]
        h = layer_norm(ALPHA * h + mix, ln1_w[l], ln1_b[l])
        ffn = peer_ffn(h, w_pq[l], peer_sub_keys[l], peer_u[l], peer_v[l])
        h = layer_norm(ALPHA * h + ffn, ln2_w[l], ln2_b[l])
    return h
```

```cpp
#include <hip/hip_runtime.h>
#include <math.h>

namespace {
constexpr int S = 8192, D = 1024, NB = 2, INC = 2816;
constexpr int O_RQ = 0, O_RK = 512, O_RV = 1024, O_RG = 1536, O_SQ = 2048, O_SK = 2560, O_SV = 2688;
constexpr float ALPHA = 1.189207115002721f;

__device__ __forceinline__ float wsum(float v) {
#pragma unroll
    for (int o = 1; o < 64; o <<= 1) v += __shfl_xor(v, o);
    return v;
}
__device__ __forceinline__ float wmax(float v) {
#pragma unroll
    for (int o = 1; o < 64; o <<= 1) v = fmaxf(v, __shfl_xor(v, o));
    return v;
}

__global__ __launch_bounds__(256) void k_gemm(const float* __restrict__ A, int lda, const float* __restrict__ B, int ldb, float* __restrict__ C, int ldc, int K) {
    __shared__ float As[16][68];
    __shared__ float Bs[16][68];
    const int t = threadIdx.x, tx = t & 15, ty = t >> 4;
    const int bm = blockIdx.y * 64, bn = blockIdx.x * 64;
    float acc[4][4];
#pragma unroll
    for (int i = 0; i < 4; ++i)
#pragma unroll
        for (int j = 0; j < 4; ++j) acc[i][j] = 0.f;
    for (int k0 = 0; k0 < K; k0 += 16) {
        {
            const int r = t >> 2, c4 = (t & 3) * 4;
            const float4 a = *(const float4*)(A + (size_t)(bm + r) * lda + k0 + c4);
            As[c4 + 0][r] = a.x; As[c4 + 1][r] = a.y; As[c4 + 2][r] = a.z; As[c4 + 3][r] = a.w;
            const int rb = t >> 4, cb = (t & 15) * 4;
            const float4 b = *(const float4*)(B + (size_t)(k0 + rb) * ldb + bn + cb);
            Bs[rb][cb + 0] = b.x; Bs[rb][cb + 1] = b.y; Bs[rb][cb + 2] = b.z; Bs[rb][cb + 3] = b.w;
        }
        __syncthreads();
#pragma unroll
        for (int kk = 0; kk < 16; ++kk) {
            float a[4], b[4];
#pragma unroll
            for (int i = 0; i < 4; ++i) { a[i] = As[kk][ty * 4 + i]; b[i] = Bs[kk][tx * 4 + i]; }
#pragma unroll
            for (int i = 0; i < 4; ++i)
#pragma unroll
                for (int j = 0; j < 4; ++j) acc[i][j] += a[i] * b[j];
        }
        __syncthreads();
    }
#pragma unroll
    for (int i = 0; i < 4; ++i) {
        float4 o = {acc[i][0], acc[i][1], acc[i][2], acc[i][3]};
        *(float4*)(C + (size_t)(bm + ty * 4 + i) * ldc + bn + tx * 4) = o;
    }
}

__global__ void k_rope(float* proj) {
    const int idx = blockIdx.x * blockDim.x + threadIdx.x;
    if (idx >= S * 832) return;
    const int pos = idx / 832, p = idx % 832;
    int base, i, half; float inv, sc = 1.f;
    if (p < 512) {
        const int pp = p & 255, head = pp >> 6; i = pp & 63; half = 64;
        base = (p < 256 ? O_RQ : O_RK) + head * 128;
        inv = 1.0f / powf(10000.0f, (float)(2 * i) / 128.0f);
        if (p >= 256) sc = 0.08838834764831845f;
    } else if (p < 768) {
        const int pp = p - 512, head = pp >> 5; i = pp & 31; half = 32;
        base = O_SQ + head * 64;
        inv = 1.0f / powf(10000.0f, (float)(2 * i) / 64.0f);
    } else {
        const int pp = p - 768, head = pp >> 5; i = pp & 31; half = 32;
        base = O_SK + head * 64;
        inv = 1.0f / powf(10000.0f, (float)(2 * i) / 64.0f);
    }
    const float ang = (float)pos * inv;
    const float c = cosf(ang), s = sinf(ang);
    float* r = proj + (size_t)pos * INC + base;
    const float x1 = r[i], x2 = r[i + half];
    r[i] = (x1 * c - x2 * s) * sc;
    r[i + half] = (x2 * c + x1 * s) * sc;
}

__device__ __forceinline__ float log_g(int h) { return logf(1.0f - exp2f(-5.0f - (float)h)); }

__global__ __launch_bounds__(256) void k_ret_kv(const float* __restrict__ proj, float* __restrict__ kv) {
    const int n = blockIdx.x, h = blockIdx.y, ds = blockIdx.z, t = threadIdx.x;
    const int e = t & 127, d0 = ds * 16 + (t >> 7) * 8;
    const float lg = log_g(h);
    float acc[8];
#pragma unroll
    for (int i = 0; i < 8; ++i) acc[i] = 0.f;
    for (int m = 0; m < 128; ++m) {
        const float* row = proj + (size_t)(n * 128 + m) * INC;
        const float vv = row[O_RV + h * 128 + e] * expf((float)(127 - m) * lg);
#pragma unroll
        for (int i = 0; i < 8; ++i) acc[i] += row[O_RK + h * 128 + d0 + i] * vv;
    }
#pragma unroll
    for (int i = 0; i < 8; ++i) kv[((size_t)(h * 64 + n) * 128 + d0 + i) * 128 + e] = acc[i];
}
__global__ void k_ret_scan(float* kv) {
    const int idx = blockIdx.x * blockDim.x + threadIdx.x;
    if (idx >= 4 * 16384) return;
    const int h = idx >> 14, de = idx & 16383;
    const float gc = expf(128.0f * log_g(h));
    float st = 0.f;
    for (int n = 0; n < 64; ++n) {
        float* p = kv + ((size_t)(h * 64 + n) << 14) + de;
        const float tmp = *p; *p = st; st = st * gc + tmp;
    }
}
__global__ __launch_bounds__(256) void k_ret_out(const float* __restrict__ proj, const float* __restrict__ kv, float* __restrict__ mix) {
    __shared__ float sc[64][128];
    const int n = blockIdx.x, h = blockIdx.y, c0 = blockIdx.z * 64, t = threadIdx.x;
    const float lg = log_g(h);
    for (int idx = t; idx < 64 * 128; idx += 256) {
        const int cl = idx >> 7, m = idx & 127, c = c0 + cl;
        float v = 0.f;
        if (m <= c) {
            const float* q = proj + (size_t)(n * 128 + c) * INC + O_RQ + h * 128;
            const float* k = proj + (size_t)(n * 128 + m) * INC + O_RK + h * 128;
            float dot = 0.f;
            for (int d = 0; d < 128; ++d) dot += q[d] * k[d];
            v = dot * expf((float)(c - m) * lg);
        }
        sc[cl][m] = v;
    }
    __syncthreads();
    const int e = t & 127, cs = t >> 7;
    const float* prev = kv + ((size_t)(h * 64 + n) << 14);
    for (int i = 0; i < 32; ++i) {
        const int cl = 2 * i + cs, c = c0 + cl;
        float acc = 0.f;
        for (int m = 0; m <= c; ++m) acc += sc[cl][m] * proj[(size_t)(n * 128 + m) * INC + O_RV + h * 128 + e];
        const float* q = proj + (size_t)(n * 128 + c) * INC + O_RQ + h * 128;
        float a2 = 0.f;
        for (int d = 0; d < 128; ++d) a2 += q[d] * prev[d * 128 + e];
        acc += expf((float)(c + 1) * lg) * a2;
        mix[(size_t)(n * 128 + c) * D + h * 128 + e] = acc;
    }
}
__global__ __launch_bounds__(256) void k_gn_gate(const float* __restrict__ proj, const float* __restrict__ gn_w, float* __restrict__ mix) {
    const int w = (blockIdx.x * 256 + threadIdx.x) >> 6, lane = threadIdx.x & 63;
    if (w >= S * 4) return;
    const int tok = w >> 2, h = w & 3;
    float* y = mix + (size_t)tok * D + h * 128;
    const float a = y[lane], b = y[lane + 64];
    const float mu = wsum(a + b) * (1.0f / 128.0f);
    const float da = a - mu, db = b - mu;
    const float var = wsum(da * da + db * db) * (1.0f / 128.0f);
    const float rs = 1.0f / sqrtf(var + 1e-6f);
    const float* rg = proj + (size_t)tok * INC + O_RG + h * 128;
    const float g0 = rg[lane], g1 = rg[lane + 64];
    y[lane] = (g0 / (1.0f + expf(-g0))) * (da * rs * gn_w[h * 128 + lane]);
    y[lane + 64] = (g1 / (1.0f + expf(-g1))) * (db * rs * gn_w[h * 128 + lane + 64]);
}
__global__ __launch_bounds__(256) void k_swa(const float* __restrict__ proj, const float* __restrict__ sinks, float* __restrict__ mix) {
    const int w = (blockIdx.x * 256 + threadIdx.x) >> 6, lane = threadIdx.x & 63;
    if (w >= S * 8) return;
    const int tok = w >> 3, hq = w & 7, hkv = hq >> 2;
    const float qreg = proj[(size_t)tok * INC + O_SQ + hq * 64 + lane];
    const int j0 = tok - 127 + lane, j1 = j0 + 64;
    const float* k0 = proj + (size_t)(j0 < 0 ? 0 : j0) * INC + O_SK + hkv * 64;
    const float* k1 = proj + (size_t)(j1 < 0 ? 0 : j1) * INC + O_SK + hkv * 64;
    float s0 = 0.f, s1 = 0.f;
    for (int d = 0; d < 64; ++d) { const float qd = __shfl(qreg, d); s0 += qd * k0[d]; s1 += qd * k1[d]; }
    s0 *= 0.125f; s1 *= 0.125f;
    const float NEG = -1e30f;
    if (j0 < 0) s0 = NEG;
    if (j1 < 0) s1 = NEG;
    const float sink = sinks[hq];
    const float m = fmaxf(wmax(fmaxf(s0, s1)), sink);
    const float p0 = (j0 < 0) ? 0.f : expf(s0 - m), p1 = (j1 < 0) ? 0.f : expf(s1 - m);
    const float den = wsum(p0 + p1) + expf(sink - m);
    float o = 0.f;
    for (int jj = 0; jj < 64; ++jj) {
        const float pa = __shfl(p0, jj), pb = __shfl(p1, jj);
        const int ja = tok - 127 + jj, jb = ja + 64;
        if (ja >= 0) o += pa * proj[(size_t)ja * INC + O_SV + hkv * 64 + lane];
        if (jb >= 0) o += pb * proj[(size_t)jb * INC + O_SV + hkv * 64 + lane];
    }
    mix[(size_t)tok * D + 512 + hq * 64 + lane] = o / den;
}
__global__ __launch_bounds__(256) void k_res_ln(const float* __restrict__ x, const float* __restrict__ add, const float* __restrict__ w, const float* __restrict__ b, float* __restrict__ out) {
    const int row = (blockIdx.x * 256 + threadIdx.x) >> 6, lane = threadIdx.x & 63;
    if (row >= S) return;
    float v[16]; float s = 0.f;
#pragma unroll
    for (int j = 0; j < 4; ++j) {
        const float4 a = *(const float4*)(x + (size_t)row * D + 4 * (lane + 64 * j));
        const float4 c = *(const float4*)(add + (size_t)row * D + 4 * (lane + 64 * j));
        v[4 * j + 0] = ALPHA * a.x + c.x; v[4 * j + 1] = ALPHA * a.y + c.y; v[4 * j + 2] = ALPHA * a.z + c.z; v[4 * j + 3] = ALPHA * a.w + c.w;
        s += (v[4 * j] + v[4 * j + 1]) + (v[4 * j + 2] + v[4 * j + 3]);
    }
    const float mu = wsum(s) * (1.0f / D);
    float q = 0.f;
#pragma unroll
    for (int i = 0; i < 16; ++i) { v[i] -= mu; q += v[i] * v[i]; }
    const float rs = 1.0f / sqrtf(wsum(q) * (1.0f / D) + 1e-5f);
#pragma unroll
    for (int j = 0; j < 4; ++j) {
        const float4 ww = *(const float4*)(w + 4 * (lane + 64 * j));
        const float4 bb = *(const float4*)(b + 4 * (lane + 64 * j));
        float4 o = {v[4 * j] * rs * ww.x + bb.x, v[4 * j + 1] * rs * ww.y + bb.y, v[4 * j + 2] * rs * ww.z + bb.z, v[4 * j + 3] * rs * ww.w + bb.w};
        *(float4*)(out + (size_t)row * D + 4 * (lane + 64 * j)) = o;
    }
}
__device__ __forceinline__ void wargmax(float& v, int& i) {
#pragma unroll
    for (int o = 1; o < 64; o <<= 1) {
        const float v2 = __shfl_xor(v, o); const int i2 = __shfl_xor(i, o);
        if (v2 > v || (v2 == v && i2 < i)) { v = v2; i = i2; }
    }
}
__global__ __launch_bounds__(256) void k_peer_route(const float* __restrict__ qp, const float* __restrict__ sk, int* __restrict__ eidx, float* __restrict__ eg) {
    const int w = (blockIdx.x * 256 + threadIdx.x) >> 6, lane = threadIdx.x & 63;
    if (w >= S * 8) return;
    const int tok = w >> 3, h = w & 7;
    const float NEG = -3.0e38f;
    float ts[2]; int ti[2];
    ts[0] = ts[1] = 0.f; ti[0] = ti[1] = 0;
#pragma unroll
    for (int p = 0; p < 2; ++p) {
        const float* q = qp + (size_t)tok * 2048 + h * 256 + p * 128;
        const float qa = q[lane], qb = q[lane + 64];
        const float* ka = sk + ((size_t)(h * 2 + p) * 128 + lane) * 128;
        const float* kb = ka + 64 * 128;
        float sa = 0.f, sb = 0.f;
        for (int d = 0; d < 64; ++d) { const float qd = __shfl(qa, d); sa += qd * ka[d]; sb += qd * kb[d]; }
        for (int d = 0; d < 64; ++d) { const float qd = __shfl(qb, d); sa += qd * ka[64 + d]; sb += qd * kb[64 + d]; }
        for (int r = 0; r < 16; ++r) {
            float v; int i;
            if (sa >= sb) { v = sa; i = lane; } else { v = sb; i = lane + 64; }
            wargmax(v, i);
            if (lane == r) { ts[p] = v; ti[p] = i; }
            if (i == lane) sa = NEG;
            if (i == lane + 64) sb = NEG;
        }
    }
    float cv[4];
#pragma unroll
    for (int jj = 0; jj < 4; ++jj) { const int c = lane * 4 + jj; cv[jj] = __shfl(ts[0], c >> 4) + __shfl(ts[1], c & 15); }
    float fs = 0.f; int fpos = 0;
    for (int r = 0; r < 16; ++r) {
        float v = cv[0]; int i = lane * 4;
#pragma unroll
        for (int jj = 1; jj < 4; ++jj) if (cv[jj] > v) { v = cv[jj]; i = lane * 4 + jj; }
        wargmax(v, i);
        if (lane == r) { fs = v; fpos = i; }
#pragma unroll
        for (int jj = 0; jj < 4; ++jj) if (i == lane * 4 + jj) cv[jj] = NEG;
    }
    const float mx = __shfl(fs, 0);
    const float ex = (lane < 16) ? expf(fs - mx) : 0.f;
    const float den = wsum(ex);
    const int e1 = __shfl(ti[0], fpos >> 4), e2 = __shfl(ti[1], fpos & 15);
    if (lane < 16) {
        eidx[((size_t)tok * 8 + h) * 16 + lane] = e1 * 128 + e2;
        eg[((size_t)tok * 8 + h) * 16 + lane] = ex / den;
    }
}
__global__ __launch_bounds__(256) void k_peer_apply(const float* h1, const int* __restrict__ eidx, const float* __restrict__ eg, const float* __restrict__ U, const float* __restrict__ V,
                                                    const float* __restrict__ w, const float* __restrict__ b, float* out) {
    const int row = (blockIdx.x * 256 + threadIdx.x) >> 6, lane = threadIdx.x & 63;
    if (row >= S) return;
    float4 x[4], y[4];
#pragma unroll
    for (int j = 0; j < 4; ++j) { x[j] = *(const float4*)(h1 + (size_t)row * D + 4 * (lane + 64 * j)); y[j] = float4{0.f, 0.f, 0.f, 0.f}; }
    const int ia = eidx[(size_t)row * 128 + lane], ib = eidx[(size_t)row * 128 + 64 + lane];
    const float ga = eg[(size_t)row * 128 + lane], gb = eg[(size_t)row * 128 + 64 + lane];
    for (int k = 0; k < 128; ++k) {
        const int e = (k < 64) ? __shfl(ia, k) : __shfl(ib, k - 64);
        const float g = (k < 64) ? __shfl(ga, k) : __shfl(gb, k - 64);
        const float* u = U + (size_t)e * D;
        float dot = 0.f;
#pragma unroll
        for (int j = 0; j < 4; ++j) { const float4 uu = *(const float4*)(u + 4 * (lane + 64 * j)); dot += (x[j].x * uu.x + x[j].y * uu.y) + (x[j].z * uu.z + x[j].w * uu.w); }
        dot = wsum(dot);
        const float a = 0.5f * dot * (1.0f + erff(dot * 0.7071067811865476f)) * g;
        const float* v = V + (size_t)e * D;
#pragma unroll
        for (int j = 0; j < 4; ++j) { const float4 vv = *(const float4*)(v + 4 * (lane + 64 * j)); y[j].x += a * vv.x; y[j].y += a * vv.y; y[j].z += a * vv.z; y[j].w += a * vv.w; }
    }
    float vals[16]; float s = 0.f;
#pragma unroll
    for (int j = 0; j < 4; ++j) {
        vals[4 * j] = ALPHA * x[j].x + y[j].x; vals[4 * j + 1] = ALPHA * x[j].y + y[j].y; vals[4 * j + 2] = ALPHA * x[j].z + y[j].z; vals[4 * j + 3] = ALPHA * x[j].w + y[j].w;
        s += (vals[4 * j] + vals[4 * j + 1]) + (vals[4 * j + 2] + vals[4 * j + 3]);
    }
    const float mu = wsum(s) * (1.0f / D);
    float q = 0.f;
#pragma unroll
    for (int i = 0; i < 16; ++i) { vals[i] -= mu; q += vals[i] * vals[i]; }
    const float rs = 1.0f / sqrtf(wsum(q) * (1.0f / D) + 1e-5f);
#pragma unroll
    for (int j = 0; j < 4; ++j) {
        const float4 ww = *(const float4*)(w + 4 * (lane + 64 * j));
        const float4 bb = *(const float4*)(b + 4 * (lane + 64 * j));
        float4 o = {vals[4 * j] * rs * ww.x + bb.x, vals[4 * j + 1] * rs * ww.y + bb.y, vals[4 * j + 2] * rs * ww.z + bb.z, vals[4 * j + 3] * rs * ww.w + bb.w};
        *(float4*)(out + (size_t)row * D + 4 * (lane + 64 * j)) = o;
    }
}
}

extern "C" void kernel_launch(void* const* d_in, const int* in_sizes, int n_in, void* d_out, int out_size, void* d_ws, size_t ws_size, hipStream_t stream) {
    const float* x = (const float*)d_in[0];
    const float* w_in = (const float*)d_in[1];
    const float* gn_w = (const float*)d_in[2];
    const float* sinks = (const float*)d_in[3];
    const float* w_out = (const float*)d_in[4];
    const float* ln1_w = (const float*)d_in[5];
    const float* ln1_b = (const float*)d_in[6];
    const float* w_pq = (const float*)d_in[7];
    const float* sk = (const float*)d_in[8];
    const float* pu = (const float*)d_in[9];
    const float* pv = (const float*)d_in[10];
    const float* ln2_w = (const float*)d_in[11];
    const float* ln2_b = (const float*)d_in[12];
    float* out = (float*)d_out;
    float* ws = (float*)d_ws;
    float* proj = ws;
    float* kv = proj + (size_t)S * INC;
    float* mix = kv + (size_t)4 * 64 * 16384;
    float* tmp = mix + (size_t)S * D;
    int* eidx = (int*)(tmp + (size_t)S * D);
    float* eg = (float*)(eidx + (size_t)S * 128);
    float* qp = proj;
    for (int b = 0; b < NB; ++b) {
        const float* xb = x + (size_t)b * S * D;
        float* ob = out + (size_t)b * S * D;
        k_gemm<<<dim3(INC / 64, S / 64), 256, 0, stream>>>(xb, D, w_in, INC, proj, INC, D);
        k_rope<<<(S * 832 + 255) / 256, 256, 0, stream>>>(proj);
        k_ret_kv<<<dim3(64, 4, 8), 256, 0, stream>>>(proj, kv);
        k_ret_scan<<<(4 * 16384) / 256, 256, 0, stream>>>(kv);
        k_ret_out<<<dim3(64, 4, 2), 256, 0, stream>>>(proj, kv, mix);
        k_gn_gate<<<(S * 4) / 4, 256, 0, stream>>>(proj, gn_w, mix);
        k_swa<<<(S * 8) / 4, 256, 0, stream>>>(proj, sinks, mix);
        k_gemm<<<dim3(D / 64, S / 64), 256, 0, stream>>>(mix, D, w_out, D, tmp, D, D);
        k_res_ln<<<S / 4, 256, 0, stream>>>(xb, tmp, ln1_w, ln1_b, ob);
        k_gemm<<<dim3(2048 / 64, S / 64), 256, 0, stream>>>(ob, D, w_pq, 2048, qp, 2048, D);
        k_peer_route<<<(S * 8) / 4, 256, 0, stream>>>(qp, sk, eidx, eg);
        k_peer_apply<<<S / 4, 256, 0, stream>>>(ob, eidx, eg, pu, pv, ln2_w, ln2_b, ob);
    }
}
```
